# Optimizing an MI355X kernel written in HIP

```python
import jax, jax.numpy as jnp
from jax import lax
import numpy as np

D_MODEL = 1024
BATCH = 1
SEQ = 16384
DEPTH = 2

HEAD_DIM = 64
N_ATTN_HEADS = 8
N_KV_GROUPS = 2
GQA_RATIO = N_ATTN_HEADS // N_KV_GROUPS
ATTN_WIDTH = N_ATTN_HEADS * HEAD_DIM
N_MLP_GROUPS = 8
MLP_WIDTH = N_MLP_GROUPS * HEAD_DIM
MIX_WIDTH = ATTN_WIDTH + MLP_WIDTH
KV_WIDTH = N_KV_GROUPS * HEAD_DIM
N_BRANCH = 3
GATE_WIDTH = N_ATTN_HEADS * N_BRANCH
IN_SIZES = [ATTN_WIDTH] + [KV_WIDTH] * 6 + [GATE_WIDTH, MLP_WIDTH, MLP_WIDTH]
IN_WIDTH = ATTN_WIDTH + 6 * KV_WIDTH + GATE_WIDTH + 2 * MLP_WIDTH
ROT_DIM = HEAD_DIM // 4
ROPE_THETA = 500000.0
CMP_LEN = 32
CMP_STRIDE = 16
CMP_HIDDEN = 256
SEL_LEN = 64
N_SELECT = 16
WINDOW = 512
Q_BLOCK = 128
CHUNK = 128
D_FF = 2816
CONV_WIDTH = 3
PLE_DIM = 256
NORM_EPS = 1e-6
NEG = -1e30
FORCED = 1e9

kernel_name = "hybrid_nsa_gmlp_convffn_trunk"


def rms_norm(x, gain):
    xf = x.astype(jnp.float32)
    y = xf * lax.rsqrt(jnp.mean(xf * xf, axis=-1, keepdims=True) + NORM_EPS)
    return (y * gain.astype(jnp.float32)).astype(x.dtype)


def layer_norm(x, gain, bias):
    xf = x.astype(jnp.float32)
    mu = jnp.mean(xf, axis=-1, keepdims=True)
    var = jnp.mean(jnp.square(xf - mu), axis=-1, keepdims=True)
    y = (xf - mu) * lax.rsqrt(var + NORM_EPS) * gain.astype(jnp.float32) + bias.astype(jnp.float32)
    return y.astype(x.dtype)


def rope_partial(x, pos):
    half = ROT_DIM // 2
    inv = ROPE_THETA ** (-jnp.arange(half, dtype=jnp.float32) / half)
    ang = pos.astype(jnp.float32)[:, None] * inv[None, :]
    cos = jnp.cos(ang)[:, None, :]
    sin = jnp.sin(ang)[:, None, :]
    xr = x[..., :ROT_DIM].astype(jnp.float32)
    x1, x2 = xr[..., :half], xr[..., half:]
    rot = jnp.concatenate([x1 * cos - x2 * sin, x2 * cos + x1 * sin], axis=-1).astype(x.dtype)
    return jnp.concatenate([rot, x[..., ROT_DIM:]], axis=-1)


def masked_softmax(s, mask):
    s = jnp.where(mask, s, NEG)
    m = jnp.max(s, axis=-1, keepdims=True)
    e = jnp.exp(s - m) * mask
    return e / jnp.maximum(jnp.sum(e, axis=-1, keepdims=True), 1e-30)


def compress(t, pe, w1, b1, w2, b2):
    B, S, G, D = t.shape
    r = CMP_LEN // CMP_STRIDE
    nch = S // CMP_STRIDE
    nc = nch - r + 1
    ch = t.reshape(B, nch, CMP_STRIDE, G, D)
    blocks = jnp.concatenate([ch[:, j:j + nc] for j in range(r)], axis=2)
    blocks = blocks + pe[None, None, :, None, :]
    flat = blocks.transpose(0, 1, 3, 2, 4).reshape(B, nc, G, CMP_LEN * D)
    h = jax.nn.gelu(flat @ w1 + b1)
    return h @ w2 + b2


def nsa_attention(q, kc, vc, ks, vs, kw, vw, gates):
    B, S, H, D = q.shape
    G = kc.shape[2]
    R = H // G
    nc = kc.shape[1]
    ns = S // SEL_LEN
    n_sel = min(N_SELECT, ns)
    scale = D ** -0.5
    cmp_start = jnp.arange(nc) * CMP_STRIDE
    cmp_end = cmp_start + CMP_LEN - 1
    sel_start = jnp.arange(ns) * SEL_LEN
    overlap = ((cmp_end[:, None] >= sel_start[None, :]) &
               (cmp_start[:, None] <= sel_start[None, :] + SEL_LEN - 1)).astype(jnp.float32)
    ks_blk = ks.reshape(B, ns, SEL_LEN, G, D).transpose(0, 3, 1, 2, 4)
    vs_blk = vs.reshape(B, ns, SEL_LEN, G, D).transpose(0, 3, 1, 2, 4)
    kw_pad = jnp.pad(kw, ((0, 0), (WINDOW, 0), (0, 0), (0, 0)))
    vw_pad = jnp.pad(vw, ((0, 0), (WINDOW, 0), (0, 0), (0, 0)))
    qg = q.reshape(B, S, G, R, D)
    gg = gates.reshape(B, S, G, R, N_BRANCH)
    bi = jnp.arange(B)[:, None, None, None]
    gi = jnp.arange(G)[None, :, None, None]
    blk = jnp.arange(ns)
    f32 = jnp.float32

    def block(qi):
        t0 = qi * Q_BLOCK
        tq = t0 + jnp.arange(Q_BLOCK)
        qb = lax.dynamic_slice_in_dim(qg, t0, Q_BLOCK, axis=1)
        gb = lax.dynamic_slice_in_dim(gg, t0, Q_BLOCK, axis=1)
        s_c = jnp.einsum('bqgrd,bngd->bgrqn', qb, kc, preferred_element_type=f32) * scale
        p_c = masked_softmax(s_c, cmp_end[None, :] <= tq[:, None])
        o_c = jnp.einsum('bgrqn,bngd->bqgrd', p_c.astype(vc.dtype), vc)
        imp = jnp.einsum('bgrqn,nj->bgqj', p_c, overlap)
        cur = tq // SEL_LEN
        valid = blk[None, :] <= cur[:, None]
        forced = valid & ((blk[None, :] == 0) | (blk[None, :] == cur[:, None]) | (blk[None, :] == cur[:, None] - 1))
        score = jnp.where(forced, FORCED, jnp.where(valid, imp, NEG))
        vals, idx = lax.top_k(score, n_sel)
        sel_ok = vals > NEG * 0.5
        k_g = ks_blk[bi, gi, idx].reshape(B, G, Q_BLOCK, n_sel * SEL_LEN, D)
        v_g = vs_blk[bi, gi, idx].reshape(B, G, Q_BLOCK, n_sel * SEL_LEN, D)
        kpos = idx[..., None] * SEL_LEN + jnp.arange(SEL_LEN)
        mask_s = ((kpos <= tq[:, None, None]) & sel_ok[..., None]).reshape(B, G, Q_BLOCK, n_sel * SEL_LEN)
        s_s = jnp.einsum('bqgrd,bgqkd->bgrqk', qb, k_g, preferred_element_type=f32) * scale
        p_s = masked_softmax(s_s, mask_s[:, :, None])
        o_s = jnp.einsum('bgrqk,bgqkd->bqgrd', p_s.astype(v_g.dtype), v_g)
        kwb = lax.dynamic_slice_in_dim(kw_pad, t0, Q_BLOCK + WINDOW, axis=1)
        vwb = lax.dynamic_slice_in_dim(vw_pad, t0, Q_BLOCK + WINDOW, axis=1)
        kpos_w = t0 - WINDOW + jnp.arange(Q_BLOCK + WINDOW)
        mask_w = ((kpos_w[None, :] <= tq[:, None]) & (kpos_w[None, :] > tq[:, None] - WINDOW)
                  & (kpos_w[None, :] >= 0))
        s_w = jnp.einsum('bqgrd,bkgd->bgrqk', qb, kwb, preferred_element_type=f32) * scale
        p_w = masked_softmax(s_w, mask_w)
        o_w = jnp.einsum('bgrqk,bkgd->bqgrd', p_w.astype(vwb.dtype), vwb)
        o = gb[..., 0:1] * o_c + gb[..., 1:2] * o_s + gb[..., 2:3] * o_w
        return o.reshape(B, Q_BLOCK, H * D)

    out = lax.map(block, jnp.arange(S // Q_BLOCK))
    return out.transpose(1, 0, 2, 3).reshape(B, S, H * D)


def spatial_gating(u, v, ln_g, ln_b, w_s, b_s):
    B, S, _ = u.shape
    u = jax.nn.gelu(u)
    v = layer_norm(jax.nn.gelu(v), ln_g, ln_b)
    vc = v.reshape(B, S // CHUNK, CHUNK, N_MLP_GROUPS, HEAD_DIM)
    causal = jnp.tril(jnp.ones((CHUNK, CHUNK), dtype=bool))
    ws = jnp.where(causal[None], w_s, 0)
    mixed = jnp.einsum('gts,bcsgd->bctgd', ws, vc) + b_s.T[None, None, :, :, None]
    return u * mixed.reshape(B, S, MLP_WIDTH)


def conv_ffn(x, w_up, conv_w, conv_b, w_down):
    S = x.shape[1]
    h = x @ w_up
    hp = jnp.pad(h, ((0, 0), (CONV_WIDTH - 1, 0), (0, 0)))
    hc = conv_b
    for k in range(CONV_WIDTH):
        hc = hc + hp[:, k:k + S] * conv_w[k]
    g, up = jnp.split(hc, 2, axis=-1)
    return (jax.nn.silu(g) * up) @ w_down


def setup_inputs(seed: int = 0) -> dict:
    key = jax.random.key(seed)
    ks = jax.random.split(key, 32)
    L = DEPTH

    def nrm(k, shape, scale):
        return jax.random.normal(k, shape, dtype=jnp.float32) * scale

    def gain(k, shape):
        return 1.0 + nrm(k, shape, 0.05)

    return {
        "x": nrm(ks[0], (BATCH, SEQ, D_MODEL), 1.0),
        "p": nrm(ks[1], (DEPTH, BATCH, SEQ, PLE_DIM), 1.0),
        "pre_mix_g": gain(ks[2], (L, D_MODEL)),
        "w_in": nrm(ks[3], (L, D_MODEL, IN_WIDTH), D_MODEL ** -0.5),
        "cmp_pe": nrm(ks[4], (L, 2, CMP_LEN, HEAD_DIM), 0.1),
        "cmp_w1": nrm(ks[5], (L, 2, CMP_LEN * HEAD_DIM, CMP_HIDDEN), (CMP_LEN * HEAD_DIM) ** -0.5),
        "cmp_b1": nrm(ks[6], (L, 2, CMP_HIDDEN), 0.02),
        "cmp_w2": nrm(ks[7], (L, 2, CMP_HIDDEN, HEAD_DIM), CMP_HIDDEN ** -0.5),
        "cmp_b2": nrm(ks[8], (L, 2, HEAD_DIM), 0.02),
        "gmlp_ln_g": gain(ks[9], (L, MLP_WIDTH)),
        "gmlp_ln_b": nrm(ks[10], (L, MLP_WIDTH), 0.02),
        "gmlp_ws": nrm(ks[11], (L, N_MLP_GROUPS, CHUNK, CHUNK), 0.5 * CHUNK ** -0.5),
        "gmlp_bs": 1.0 + nrm(ks[12], (L, N_MLP_GROUPS, CHUNK), 0.1),
        "attn_out_g": gain(ks[13], (L, ATTN_WIDTH)),
        "mlp_out_g": gain(ks[14], (L, MLP_WIDTH)),
        "w_o": nrm(ks[15], (L, MIX_WIDTH, D_MODEL), MIX_WIDTH ** -0.5),
        "post_mix_g": gain(ks[16], (L, D_MODEL)),
        "pre_ffn_g": gain(ks[17], (L, D_MODEL)),
        "w_up": nrm(ks[18], (L, D_MODEL, 2 * D_FF), D_MODEL ** -0.5),
        "conv_w": nrm(ks[19], (L, CONV_WIDTH, 2 * D_FF), CONV_WIDTH ** -0.5),
        "conv_b": nrm(ks[20], (L, 2 * D_FF), 0.02),
        "w_down": nrm(ks[21], (L, D_FF, D_MODEL), D_FF ** -0.5),
        "post_ffn_g": gain(ks[22], (L, D_MODEL)),
        "ple_norm_g": gain(ks[23], (L, D_MODEL)),
        "w_ple_gate": nrm(ks[24], (L, D_MODEL, D_MODEL), D_MODEL ** -0.5),
        "w_ple_proj": nrm(ks[25], (L, PLE_DIM, D_MODEL), PLE_DIM ** -0.5),
    }


def reference(x, p, pre_mix_g, w_in, cmp_pe, cmp_w1, cmp_b1, cmp_w2, cmp_b2,
              gmlp_ln_g, gmlp_ln_b, gmlp_ws, gmlp_bs, attn_out_g, mlp_out_g, w_o,
              post_mix_g, pre_ffn_g, w_up, conv_w, conv_b, w_down, post_ffn_g,
              ple_norm_g, w_ple_gate, w_ple_proj):
    B, S, _ = x.shape
    pos = jnp.arange(S)
    split_at = [int(o) for o in np.cumsum(IN_SIZES)[:-1]]
    nc = S // CMP_STRIDE - CMP_LEN // CMP_STRIDE + 1
    cmp_pos = jnp.arange(nc) * CMP_STRIDE + CMP_LEN - 1
    h = x
    for i in range(DEPTH):
        a = rms_norm(h, pre_mix_g[i])
        z = a @ w_in[i]
        zq, zkc, zvc, zks, zvs, zkw, zvw, zg, zu, zv = jnp.split(z, split_at, axis=-1)
        kv = lambda t: t.reshape(B, S, N_KV_GROUPS, HEAD_DIM)
        q = rope_partial(zq.reshape(B, S, N_ATTN_HEADS, HEAD_DIM), pos)
        kc = compress(kv(zkc), cmp_pe[i, 0], cmp_w1[i, 0], cmp_b1[i, 0], cmp_w2[i, 0], cmp_b2[i, 0])
        vc = compress(kv(zvc), cmp_pe[i, 1], cmp_w1[i, 1], cmp_b1[i, 1], cmp_w2[i, 1], cmp_b2[i, 1])
        kc = rope_partial(kc, cmp_pos)
        k_sel = rope_partial(kv(zks), pos)
        k_win = rope_partial(kv(zkw), pos)
        gates = jax.nn.sigmoid(zg.reshape(B, S, N_ATTN_HEADS, N_BRANCH))
        attn = nsa_attention(q, kc, vc, k_sel, kv(zvs), k_win, kv(zvw), gates)
        mlp = spatial_gating(zu, zv, gmlp_ln_g[i], gmlp_ln_b[i], gmlp_ws[i], gmlp_bs[i])
        mix = jnp.concatenate([rms_norm(attn, attn_out_g[i]), rms_norm(mlp, mlp_out_g[i])], axis=-1) @ w_o[i]
        h = h + rms_norm(mix, post_mix_g[i])
        f = conv_ffn(rms_norm(h, pre_ffn_g[i]), w_up[i], conv_w[i], conv_b[i], w_down[i])
        h = h + rms_norm(f, post_ffn_g[i])
        gate = jax.nn.sigmoid(rms_norm(h, ple_norm_g[i]) @ w_ple_gate[i])
        h = h + gate * (p[i] @ w_ple_proj[i])
    return h
```

```cpp
#include <hip/hip_runtime.h>
#include <cstdio>
#include <cstdint>

typedef unsigned short bf16;

constexpr int S = 16384, DM = 1024, NL = 2, HD = 64, NH = 8;
constexpr int NIN = 2328, NINP = 2560, DFF = 2816, NUP = 2 * DFF, PLE = 256;
constexpr int NCMP = 1023;
constexpr float EPS = 1e-6f;
constexpr float C2 = 0.125f * 1.4426950408889634f;

constexpr size_t MiB = 1u << 20;
constexpr size_t WS_CTL = 0, WS_ROPE = 1 * MiB, WS_XBUF = 2 * MiB, WS_MISC = 3 * MiB;
constexpr size_t WS_W = 4 * MiB, WL_STRIDE = 29 * MiB;
constexpr size_t WO_WIN = 0, WO_WO = 5 * MiB, WO_WUP = 7 * MiB, WO_WDN = 18 * MiB, WO_WPG = 18 * MiB + 5632 * 1024, WO_WPP = WO_WPG + 2 * MiB,
                 WO_CW1 = 26 * MiB, WO_CW2 = 28 * MiB, WO_GWS = 28 * MiB + 256 * 1024;
constexpr size_t WS_XA = 64 * MiB, WS_XB = 96 * MiB, WS_PROJ = 128 * MiB, WS_ACT = 160 * MiB, WS_PB = 248 * MiB, WS_END = 256 * MiB;
constexpr size_t WS_Q = 160 * MiB, WS_U = 176 * MiB, WS_VG = 192 * MiB, WS_KVC = 208 * MiB, WS_KS = 216 * MiB, WS_KW = 220 * MiB, WS_VS = 224 * MiB,
                 WS_VW = 228 * MiB, WS_VST = 232 * MiB, WS_VWT = 236 * MiB, WS_G = 240 * MiB, WS_KC = 242 * MiB, WS_VCT = 242 * MiB + 256 * 1024,
                 WS_VCR = 242 * MiB + 512 * 1024;
static_assert(WO_WPP + 512 * 1024 <= WO_CW1 && WO_GWS + 256 * 1024 <= WL_STRIDE && WS_W + 2 * WL_STRIDE <= WS_XA, "weights map");

__device__ __forceinline__ float bf2f(bf16 v) { return __uint_as_float((unsigned)v << 16); }
__device__ __forceinline__ bf16 f2bf(float f) { unsigned u = __float_as_uint(f); return (bf16)((u + 0x7fffu + ((u >> 16) & 1u)) >> 16); }
__device__ __forceinline__ float gelu_tanh(float x) { const float u = 0.7978845608028654f * (x + 0.044715f * x * x * x); return 0.5f * x * (1.f + tanhf(u)); }
__device__ __forceinline__ float sigmoidf_(float x) { return 1.f / (1.f + __expf(-x)); }
__device__ __forceinline__ float wave_max(float v) { for (int o = 32; o > 0; o >>= 1) v = fmaxf(v, __shfl_xor(v, o)); return v; }
__device__ __forceinline__ float wave_sum(float v) { for (int o = 32; o > 0; o >>= 1) v += __shfl_xor(v, o); return v; }

namespace nv {

__global__ void rope_table(float* rope) {
    const int idx = blockIdx.x * 256 + threadIdx.x; if (idx >= S * 8) return;
    const int t = idx >> 3, i = idx & 7;
    const float inv = (float)pow(500000.0, -(double)i / 8.0);
    const float ang = (float)t * inv;
    rope[2 * idx] = (float)cos((double)ang); rope[2 * idx + 1] = (float)sin((double)ang);
}

template <int MODE> __device__ __forceinline__ int src_col(int n) {
    if (MODE == 1) {
        if (n < 768) return n; if (n < 896) return n;   if (n < 1024) return n + 128;   if (n < 1152) return n - 128;
        if (n < 1280) return n;   if (n < 1792) return n + 24;   if (n < 2304) return n + 24;   if (n < 2328) return n - 1024;   return -1;
    }
    if (MODE == 3) { const int j = n >> 8, i = n & 255; return (i < 128) ? (128 * j + i) : (DFF + 128 * j + (i - 128)); }
    return n;
}
template <int MODE> __global__ void convT(const float* W, int K, int N, bf16* out, const float* s0, const float* s1) {
    __shared__ float tl[32][33];
    const int tx = threadIdx.x & 31, ty = threadIdx.x >> 5, k0 = blockIdx.x * 32, n0 = blockIdx.y * 32;
    const int src = src_col<MODE>(n0 + tx);
#pragma unroll
    for (int i = 0; i < 4; ++i) { const int k = k0 + ty + 8 * i; float sc = 1.f;
        if (MODE == 1 || MODE == 3 || MODE == 4) sc = s0[k]; if (MODE == 2) sc = (k < 512) ? s0[k] : s1[k - 512];
        tl[ty + 8 * i][tx] = (src >= 0) ? W[(size_t)k * N + src] * sc : 0.f; }
    __syncthreads();
#pragma unroll
    for (int i = 0; i < 4; ++i) { const int n = n0 + ty + 8 * i, k = k0 + tx; out[(size_t)n * K + k] = f2bf(tl[tx][ty + 8 * i]); }
}
__global__ void conv_gws(const float* ws, bf16* out) {
    const int idx = blockIdx.x * 256 + threadIdx.x; if (idx >= 8 * 128 * 128) return;
    const int s = idx & 127, t = (idx >> 7) & 127; out[idx] = f2bf(s <= t ? ws[idx] : 0.f);
}
__global__ void cmp_c1(const float* pe  , const float* w1  , const float* b1  , float* c1  ) {
    const int idx = blockIdx.x * 256 + threadIdx.x; if (idx >= 512) return; const int kv = idx >> 8, n = idx & 255;
    float a = b1[idx]; for (int k = 0; k < 2048; ++k) a += pe[kv * 2048 + k] * w1[((size_t)kv * 2048 + k) * 256 + n]; c1[idx] = a;
}
__global__ void f32_to_bf16(const float* in, bf16* out, size_t n) { size_t i = (size_t)blockIdx.x * 256 + threadIdx.x; if (i < n) out[i] = f2bf(in[i]); }

template <int NC> __global__ void rms_rows(const float* X, bf16* out, int out_pitch, int col0) {
    const int row = blockIdx.x * 4 + (threadIdx.x >> 6), lane = threadIdx.x & 63; const float* x = X + (size_t)row * NC;
    float v[NC / 64]; float ss = 0.f;
#pragma unroll
    for (int j = 0; j < NC / 64; ++j) { v[j] = x[lane + 64 * j]; ss += v[j] * v[j]; }
    const float r = rsqrtf(wave_sum(ss) * (1.f / NC) + EPS);
#pragma unroll
    for (int j = 0; j < NC / 64; ++j) out[(size_t)row * out_pitch + col0 + lane + 64 * j] = f2bf(v[j] * r);
}
__global__ void res_norm(const float* Hin, const float* T, const float* gain, float* Hout, bf16* Aout) {
    const int row = blockIdx.x * 4 + (threadIdx.x >> 6), lane = threadIdx.x & 63; const size_t o = (size_t)row * DM;
    float t[16], h[16]; float ss = 0.f;
#pragma unroll
    for (int j = 0; j < 16; ++j) { t[j] = T[o + lane + 64 * j]; ss += t[j] * t[j]; }
    const float r = rsqrtf(wave_sum(ss) * (1.f / DM) + EPS); float s2 = 0.f;
#pragma unroll
    for (int j = 0; j < 16; ++j) { h[j] = Hin[o + lane + 64 * j] + t[j] * r * gain[lane + 64 * j]; s2 += h[j] * h[j]; }
    const float r2 = rsqrtf(wave_sum(s2) * (1.f / DM) + EPS);
#pragma unroll
    for (int j = 0; j < 16; ++j) { Hout[o + lane + 64 * j] = h[j]; Aout[o + lane + 64 * j] = f2bf(h[j] * r2); }
}
__global__ void ple_rows(float* H, const float* Gt, const bf16* P, bf16* Aout) {
    const int row = blockIdx.x * 4 + (threadIdx.x >> 6), lane = threadIdx.x & 63; const size_t o = (size_t)row * DM;
    float h[16]; float s2 = 0.f;
#pragma unroll
    for (int j = 0; j < 16; ++j) { const size_t i = o + lane + 64 * j; h[j] = H[i] + sigmoidf_(Gt[i]) * bf2f(P[i]); s2 += h[j] * h[j]; }
    const float r2 = rsqrtf(wave_sum(s2) * (1.f / DM) + EPS);
#pragma unroll
    for (int j = 0; j < 16; ++j) { H[o + lane + 64 * j] = h[j]; Aout[o + lane + 64 * j] = f2bf(h[j] * r2); }
}

struct TileView { const float* ct; int m0, n0; __device__ float at(int m, int n) const { return ct[(m - m0) * 65 + (n - n0)]; } };
template <class Epi> __global__ void __launch_bounds__(256) gemm(const bf16* A, int lda, int arow0, const bf16* Bt, int K, int M, Epi epi) {
    __shared__ float sm[64 * 65]; float* As = sm; float* Bs = sm + 16 * 65;
    const int tid = threadIdx.x, tx = tid & 15, ty = tid >> 4, m0 = blockIdx.y * 64, n0 = blockIdx.x * 64;
    float acc[4][4] = {};
    const int lr = tid >> 2, lk = (tid & 3) * 4;
    for (int k0 = 0; k0 < K; k0 += 16) {
        { const int m = m0 + lr; float a[4] = {0.f, 0.f, 0.f, 0.f}; const long ar = (long)arow0 + m;
          if (m < M && ar >= 0) { const bf16* p = A + (size_t)ar * lda + k0 + lk; for (int i = 0; i < 4; ++i) a[i] = bf2f(p[i]); }
          for (int i = 0; i < 4; ++i) As[(lk + i) * 65 + lr] = a[i];
          const bf16* q = Bt + (size_t)(n0 + lr) * K + k0 + lk; for (int i = 0; i < 4; ++i) Bs[(lk + i) * 65 + lr] = bf2f(q[i]); }
        __syncthreads();
#pragma unroll
        for (int k = 0; k < 16; ++k) { float a[4], b[4];
#pragma unroll
            for (int i = 0; i < 4; ++i) { a[i] = As[k * 65 + ty * 4 + i]; b[i] = Bs[k * 65 + tx * 4 + i]; }
#pragma unroll
            for (int i = 0; i < 4; ++i)
#pragma unroll
                for (int j = 0; j < 4; ++j) acc[i][j] += a[i] * b[j]; }
        __syncthreads();
    }
    for (int i = 0; i < 4; ++i) for (int j = 0; j < 4; ++j) sm[(ty * 4 + i) * 65 + tx * 4 + j] = acc[i][j];
    __syncthreads();
    TileView tv{sm, m0, n0};
    for (int i = 0; i < 4; ++i) for (int j = 0; j < 4; ++j) { const int m = m0 + ty * 4 + i, n = n0 + tx * 4 + j; if (m < M) epi(m, n, tv); }
}
struct EpiF32 { float* C; int ldc; __device__ void operator()(int m, int n, const TileView& t) const { C[(size_t)m * ldc + n] = t.at(m, n); } };
struct EpiBf { bf16* C; int ldc; __device__ void operator()(int m, int n, const TileView& t) const { C[(size_t)m * ldc + n] = f2bf(t.at(m, n)); } };
struct EpiIn {
    bf16 *Q, *KVC, *KS, *KW, *VS, *VW, *U, *VG; float* G; const float* rope;
    __device__ float roped(int m, int n, const TileView& t) const {
        const int d = n & 63; const float v = t.at(m, n); if (d >= 16) return v;
        const int i = d & 7; const float c = rope[((size_t)m * 8 + i) * 2], s = rope[((size_t)m * 8 + i) * 2 + 1];
        return (d < 8) ? v * c - t.at(m, n + 8) * s : v * c + t.at(m, n - 8) * s;
    }
    __device__ void operator()(int m, int n, const TileView& t) const {
        if (n < 512) Q[(size_t)m * 512 + n] = f2bf(roped(m, n, t) * C2);
        else if (n < 768) KVC[(size_t)m * 256 + n - 512] = f2bf(t.at(m, n));
        else if (n < 896) KS[(size_t)m * 128 + n - 768] = f2bf(roped(m, n, t));
        else if (n < 1024) KW[(size_t)m * 128 + n - 896] = f2bf(roped(m, n, t));
        else if (n < 1152) VS[(size_t)m * 128 + n - 1024] = f2bf(t.at(m, n));
        else if (n < 1280) VW[(size_t)m * 128 + n - 1152] = f2bf(t.at(m, n));
        else if (n < 1792) U[(size_t)m * 512 + n - 1280] = f2bf(gelu_tanh(t.at(m, n)));
        else if (n < 2304) VG[(size_t)m * 512 + n - 1792] = f2bf(gelu_tanh(t.at(m, n)));
        else if (n < 2328) G[(size_t)m * 32 + n - 2304] = sigmoidf_(t.at(m, n));
    }
};

__global__ void __launch_bounds__(256) compress(const bf16* KVC, const float* w1, const float* c1, const float* w2, const float* b2, const float* rope, bf16* KC, bf16* VCr) {
    __shared__ bf16 a[8][2048]; __shared__ float h1[8][256]; __shared__ float so[8][64];
    const int tid = threadIdx.x, i0 = blockIdx.x * 8, g = blockIdx.y, kv = blockIdx.z;
    for (int idx = tid; idx < 8 * 2048; idx += 256) { const int j = idx >> 11, k = idx & 2047, l = k >> 6, d = k & 63, i = i0 + j;
        a[j][k] = (i < NCMP) ? KVC[(size_t)(16 * i + l) * 256 + kv * 128 + g * 64 + d] : (bf16)0; }
    __syncthreads();
    { const int n = tid; float acc[8]; for (int j = 0; j < 8; ++j) acc[j] = c1[kv * 256 + n];
      const float* w = w1 + (size_t)kv * 2048 * 256 + n;
      for (int k = 0; k < 2048; ++k) { const float wv = w[(size_t)k * 256]; for (int j = 0; j < 8; ++j) acc[j] += bf2f(a[j][k]) * wv; }
      for (int j = 0; j < 8; ++j) h1[j][n] = gelu_tanh(acc[j]); }
    __syncthreads();
    for (int o = tid; o < 512; o += 256) { const int j = o >> 6, e = o & 63; float acc = b2[kv * 64 + e];
        for (int n = 0; n < 256; ++n) acc += h1[j][n] * w2[((size_t)kv * 256 + n) * 64 + e]; so[j][e] = acc; }
    __syncthreads();
    for (int o = tid; o < 512; o += 256) { const int j = o >> 6, e = o & 63, i = i0 + j; float v = so[j][e];
        if (kv == 0 && e < 16 && i < NCMP) { const int pos = 16 * i + 31, ii = e & 7; const float c = rope[((size_t)pos * 8 + ii) * 2], s = rope[((size_t)pos * 8 + ii) * 2 + 1];
            v = (e < 8) ? v * c - so[j][e + 8] * s : v * c + so[j][e - 8] * s; }
        if (i >= NCMP) v = 0.f;
        (kv == 0 ? KC : VCr)[((size_t)g * 1024 + i) * 64 + e] = f2bf(v); }
}

__global__ void ln_rows(const bf16* VG, const float* lg, const float* lb, bf16* VN) {
    const int row = blockIdx.x * 4 + (threadIdx.x >> 6), lane = threadIdx.x & 63; const size_t o = (size_t)row * 512;
    float v[8]; float s = 0.f;
#pragma unroll
    for (int j = 0; j < 8; ++j) { v[j] = bf2f(VG[o + lane + 64 * j]); s += v[j]; }
    const float mu = wave_sum(s) * (1.f / 512); float q = 0.f;
#pragma unroll
    for (int j = 0; j < 8; ++j) { v[j] -= mu; q += v[j] * v[j]; }
    const float r = rsqrtf(wave_sum(q) * (1.f / 512) + EPS);
#pragma unroll
    for (int j = 0; j < 8; ++j) { const int c = lane + 64 * j; VN[o + c] = f2bf(v[j] * r * lg[c] + lb[c]); }
}
__global__ void __launch_bounds__(256) gmlp_mix(const bf16* VN, const bf16* U, const float* ws, const float* bs, float* MLPraw) {
    __shared__ float vn[128][64];
    const int tid = threadIdx.x, c = blockIdx.x, g = blockIdx.y;
    for (int idx = tid; idx < 128 * 64; idx += 256) { const int s = idx >> 6, d = idx & 63; vn[s][d] = bf2f(VN[(size_t)(c * 128 + s) * 512 + g * 64 + d]); }
    __syncthreads();
    const int d = tid & 63, tq = tid >> 6;
    for (int i = 0; i < 32; ++i) { const int t = tq + 4 * i; float acc = bs[g * 128 + t]; const float* w = ws + ((size_t)g * 128 + t) * 128;
        for (int s = 0; s <= t; ++s) acc += w[s] * vn[s][d];
        const size_t o = (size_t)(c * 128 + t) * 512 + g * 64 + d; MLPraw[o] = bf2f(U[o]) * acc; }
}

__global__ void conv_act(const bf16* HU, int trow0, int t0, const float* cw  , const float* cb  , bf16* ACT) {
    const int c = blockIdx.x * 256 + threadIdx.x; if (c >= DFF) return; const int t = t0 + blockIdx.y;
    const int cg = (c >> 7) * 256 + (c & 127), cu = cg + 128;
    float hg = cb[c], hu = cb[DFF + c];
#pragma unroll
    for (int j = 0; j < 3; ++j) { const int tt = t - 2 + j; if (tt >= 0) { const size_t o = (size_t)(tt - trow0) * NUP; hg += cw[j * NUP + c] * bf2f(HU[o + cg]); hu += cw[j * NUP + DFF + c] * bf2f(HU[o + cu]); } }
    ACT[(size_t)t * DFF + c] = f2bf(hg * sigmoidf_(hg) * hu);
}

__device__ void softmax4(float (*sc)[1024], int n, float* red, int tid) {
    const int lane = tid & 63, w = tid >> 6;
    float mx[4] = {-3e38f, -3e38f, -3e38f, -3e38f};
    for (int i = tid; i < n; i += 256) for (int r = 0; r < 4; ++r) mx[r] = fmaxf(mx[r], sc[r][i]);
    for (int r = 0; r < 4; ++r) { mx[r] = wave_max(mx[r]); if (lane == 0) red[r * 4 + w] = mx[r]; }
    __syncthreads();
    for (int r = 0; r < 4; ++r) mx[r] = fmaxf(fmaxf(red[r * 4], red[r * 4 + 1]), fmaxf(red[r * 4 + 2], red[r * 4 + 3]));
    __syncthreads();
    float sm[4] = {0.f, 0.f, 0.f, 0.f};
    for (int i = tid; i < n; i += 256) for (int r = 0; r < 4; ++r) { const float s = sc[r][i]; const float e = (s > -1e37f) ? exp2f(s - mx[r]) : 0.f; sc[r][i] = e; sm[r] += e; }
    for (int r = 0; r < 4; ++r) { sm[r] = wave_sum(sm[r]); if (lane == 0) red[r * 4 + w] = sm[r]; }
    __syncthreads();
    for (int r = 0; r < 4; ++r) sm[r] = 1.f / fmaxf(red[r * 4] + red[r * 4 + 1] + red[r * 4 + 2] + red[r * 4 + 3], 1e-30f);
    __syncthreads();
    for (int i = tid; i < n; i += 256) for (int r = 0; r < 4; ++r) sc[r][i] *= sm[r];
    __syncthreads();
}
__device__ __forceinline__ void dot4(const float (*q)[64], const bf16* krow, float* s) {
    s[0] = s[1] = s[2] = s[3] = 0.f;
    for (int d = 0; d < 64; ++d) { const float kv = bf2f(krow[d]); s[0] += q[0][d] * kv; s[1] += q[1][d] * kv; s[2] += q[2][d] * kv; s[3] += q[3][d] * kv; }
}
__global__ void __launch_bounds__(256) attn(const bf16* Q, const bf16* KC, const bf16* VCr, const bf16* KS, const bf16* VS, const bf16* KW, const bf16* VW, const float* G, float* ATT) {
    __shared__ float q[4][64]; __shared__ float sc[4][1024]; __shared__ float red[16]; __shared__ float score[256]; __shared__ int sel[16]; __shared__ int selok[16];
    __shared__ float rv[4]; __shared__ int ri[4];
    const int tid = threadIdx.x, lane = tid & 63, w = tid >> 6, t = blockIdx.x >> 1, g = blockIdx.x & 1;
    q[tid >> 6][tid & 63] = bf2f(Q[(size_t)t * 512 + (g * 4 + (tid >> 6)) * 64 + (tid & 63)]);
    __syncthreads();
    const int r_ = tid >> 6, d_ = tid & 63;
    float o_c = 0.f, o_s = 0.f, o_w = 0.f;
    const int ncv = (t >= 31) ? (t - 31) / 16 + 1 : 0;
    for (int n = tid; n < ncv; n += 256) { float s[4]; dot4(q, KC + ((size_t)g * 1024 + n) * 64, s); for (int r = 0; r < 4; ++r) sc[r][n] = s[r]; }
    __syncthreads();
    softmax4(sc, ncv, red, tid);
    { const int j = tid; float im = 0.f; for (int n = 4 * j - 1; n <= 4 * j + 3; ++n) if (n >= 0 && n < ncv) im += sc[0][n] + sc[1][n] + sc[2][n] + sc[3][n];
      const int cur = t >> 6; const bool valid = j <= cur, forced = valid && (j == 0 || j == cur || j == cur - 1);
      score[j] = forced ? 1e9f : (valid ? im : -1e30f); }
    for (int n = 0; n < ncv; ++n) o_c += sc[r_][n] * bf2f(VCr[((size_t)g * 1024 + n) * 64 + d_]);
    __syncthreads();
    for (int it = 0; it < 16; ++it) {
        float v = score[tid]; int ix = tid;
        for (int o = 32; o > 0; o >>= 1) { const float ov = __shfl_xor(v, o); const int oi = __shfl_xor(ix, o); if (ov > v || (ov == v && oi < ix)) { v = ov; ix = oi; } }
        if (lane == 0) { rv[w] = v; ri[w] = ix; }
        __syncthreads();
        if (tid == 0) { float bv = rv[0]; int bi = ri[0]; for (int k = 1; k < 4; ++k) if (rv[k] > bv || (rv[k] == bv && ri[k] < bi)) { bv = rv[k]; bi = ri[k]; }
            sel[it] = bi; selok[it] = bv > -5e29f; score[bi] = -3e38f; }
        __syncthreads();
    }
    for (int e = tid; e < 1024; e += 256) { const int i = e >> 6, x = e & 63; const int kpos = sel[i] * 64 + x;
        if (selok[i] && kpos <= t) { float s[4]; dot4(q, KS + (size_t)kpos * 128 + g * 64, s); for (int r = 0; r < 4; ++r) sc[r][e] = s[r]; }
        else for (int r = 0; r < 4; ++r) sc[r][e] = -3e38f; }
    __syncthreads();
    softmax4(sc, 1024, red, tid);
    for (int e = 0; e < 1024; ++e) { const float p = sc[r_][e]; if (p != 0.f) { const int kpos = sel[e >> 6] * 64 + (e & 63); o_s += p * bf2f(VS[(size_t)kpos * 128 + g * 64 + d_]); } }
    __syncthreads();
    const int w0 = (t >= 511) ? t - 511 : 0, nw = t - w0 + 1;
    for (int e = tid; e < nw; e += 256) { float s[4]; dot4(q, KW + (size_t)(w0 + e) * 128 + g * 64, s); for (int r = 0; r < 4; ++r) sc[r][e] = s[r]; }
    __syncthreads();
    softmax4(sc, nw, red, tid);
    for (int e = 0; e < nw; ++e) o_w += sc[r_][e] * bf2f(VW[(size_t)(w0 + e) * 128 + g * 64 + d_]);
    const float* gt = G + (size_t)t * 32 + (g * 4 + r_) * 3;
    ATT[(size_t)t * 512 + (g * 4 + r_) * 64 + d_] = gt[0] * o_c + gt[1] * o_s + gt[2] * o_w;
}
}

struct Ptrs {
    const float* in[26]; float* out; unsigned char* ws;
};
static inline bf16* W16(unsigned char* ws, int l, size_t off) { return (bf16*)(ws + WS_W + (size_t)l * WL_STRIDE + off); }

extern "C" void kernel_launch(void* const* d_in, const int* in_sizes, int n_in, void* d_out, int out_size, void* d_ws, size_t ws_size, hipStream_t stream) {
    if (n_in != 26 || out_size != S * DM || ws_size < WS_END) { fprintf(stderr, "kernel_launch: unexpected shapes (n_in %d out %d ws %zu)\n", n_in, out_size, ws_size); return; }
    const float* in[26]; for (int i = 0; i < 26; ++i) in[i] = (const float*)d_in[i];
    unsigned char* ws = (unsigned char*)d_ws; float* out = (float*)d_out;
    float* rope = (float*)(ws + WS_ROPE); float* c1 = (float*)(ws + WS_MISC);
    const float *x = in[0], *p = in[1];
    nv::rope_table<<<S * 8 / 256, 256, 0, stream>>>(rope);
    for (int l = 0; l < NL; ++l) {
        const float* w_in = in[3] + (size_t)l * DM * NIN; const float* w_o = in[15] + (size_t)l * DM * DM; const float* w_up = in[18] + (size_t)l * DM * NUP;
        const float* w_dn = in[21] + (size_t)l * DFF * DM; const float* w_pg = in[24] + (size_t)l * DM * DM; const float* w_pp = in[25] + (size_t)l * PLE * DM;
        nv::convT<1><<<dim3(DM / 32, NINP / 32), 256, 0, stream>>>(w_in, DM, NIN, W16(ws, l, WO_WIN), in[2] + l * DM, nullptr);
        nv::convT<2><<<dim3(DM / 32, DM / 32), 256, 0, stream>>>(w_o, DM, DM, W16(ws, l, WO_WO), in[13] + l * 512, in[14] + l * 512);
        nv::convT<3><<<dim3(DM / 32, NUP / 32), 256, 0, stream>>>(w_up, DM, NUP, W16(ws, l, WO_WUP), in[17] + l * DM, nullptr);
        nv::convT<0><<<dim3(DFF / 32, DM / 32), 256, 0, stream>>>(w_dn, DFF, DM, W16(ws, l, WO_WDN), nullptr, nullptr);
        nv::convT<4><<<dim3(DM / 32, DM / 32), 256, 0, stream>>>(w_pg, DM, DM, W16(ws, l, WO_WPG), in[23] + l * DM, nullptr);
        nv::convT<0><<<dim3(PLE / 32, DM / 32), 256, 0, stream>>>(w_pp, PLE, DM, W16(ws, l, WO_WPP), nullptr, nullptr);
        nv::cmp_c1<<<2, 256, 0, stream>>>(in[4] + (size_t)l * 2 * 2048, in[5] + (size_t)l * 2 * 2048 * 256, in[6] + l * 512, c1 + l * 512);
    }
    bf16 *XA = (bf16*)(ws + WS_XA), *XB = (bf16*)(ws + WS_XB);
    nv::rms_rows<1024><<<S / 4, 256, 0, stream>>>(x, XA, DM, 0);
    const float* hin = x;
    for (int l = 0; l < NL; ++l) {
        bf16 *Q = (bf16*)(ws + WS_Q), *KVC = (bf16*)(ws + WS_KVC), *KS = (bf16*)(ws + WS_KS), *KW = (bf16*)(ws + WS_KW), *VS = (bf16*)(ws + WS_VS), *VW = (bf16*)(ws + WS_VW),
             *U = (bf16*)(ws + WS_U), *VG = (bf16*)(ws + WS_VG), *KC = (bf16*)(ws + WS_KC), *VCr = (bf16*)(ws + WS_VCR);
        float* G = (float*)(ws + WS_G);
        nv::EpiIn e1{Q, KVC, KS, KW, VS, VW, U, VG, G, rope};
        nv::gemm<nv::EpiIn><<<dim3(NINP / 64, S / 64), 256, 0, stream>>>(XA, DM, 0, W16(ws, l, WO_WIN), DM, S, e1);
        nv::compress<<<dim3(128, 2, 2), 256, 0, stream>>>(KVC, in[5] + (size_t)l * 2 * 2048 * 256, c1 + l * 512, in[7] + (size_t)l * 2 * 256 * 64, in[8] + l * 128, rope, KC, VCr);
        bf16* VN = (bf16*)(ws + WS_PROJ); float* MLPraw = (float*)XA; float* ATTraw = (float*)(ws + WS_PROJ);
        nv::ln_rows<<<S / 4, 256, 0, stream>>>(VG, in[9] + l * 512, in[10] + l * 512, VN);
        nv::gmlp_mix<<<dim3(S / 128, 8), 256, 0, stream>>>(VN, U, in[11] + (size_t)l * 8 * 128 * 128, in[12] + l * 8 * 128, MLPraw);
        nv::attn<<<S * 2, 256, 0, stream>>>(Q, KC, VCr, KS, VS, KW, VW, G, ATTraw);
        nv::rms_rows<512><<<S / 4, 256, 0, stream>>>(ATTraw, XB, DM, 0);
        nv::rms_rows<512><<<S / 4, 256, 0, stream>>>(MLPraw, XB, DM, 512);
        float* T64 = (float*)(ws + WS_ACT);
        nv::gemm<nv::EpiF32><<<dim3(DM / 64, S / 64), 256, 0, stream>>>(XB, DM, 0, W16(ws, l, WO_WO), DM, S, nv::EpiF32{T64, DM});
        nv::res_norm<<<S / 4, 256, 0, stream>>>(hin, T64, in[16] + l * DM, out, XA);
        bf16* HU = (bf16*)(ws + WS_PROJ); bf16* ACT = (bf16*)(ws + WS_ACT);
        for (int c = 0; c < 8; ++c) { const int t0 = c * 2048, r0 = t0 - 2;
            nv::gemm<nv::EpiBf><<<dim3(NUP / 64, (2050 + 63) / 64), 256, 0, stream>>>(XA, DM, r0, W16(ws, l, WO_WUP), DM, 2050, nv::EpiBf{HU, NUP});
            nv::conv_act<<<dim3(DFF / 256, 2048), 256, 0, stream>>>(HU, r0, t0, in[19] + (size_t)l * 3 * NUP, in[20] + l * NUP, ACT); }
        float* F32 = (float*)(ws + WS_PROJ);
        for (int c = 0; c < 2; ++c) { const size_t ro = (size_t)c * 8192;
            nv::gemm<nv::EpiF32><<<dim3(DM / 64, 8192 / 64), 256, 0, stream>>>(ACT + ro * DFF, DFF, 0, W16(ws, l, WO_WDN), DFF, 8192, nv::EpiF32{F32, DM});
            nv::res_norm<<<8192 / 4, 256, 0, stream>>>(out + ro * DM, F32, in[22] + l * DM, out + ro * DM, XA + ro * DM); }
        bf16* PB = (bf16*)(ws + WS_PB); bf16* PROJ = (bf16*)(ws + WS_PROJ);
        nv::f32_to_bf16<<<(S * PLE) / 256, 256, 0, stream>>>(p + (size_t)l * S * PLE, PB, (size_t)S * PLE);
        nv::gemm<nv::EpiBf><<<dim3(DM / 64, S / 64), 256, 0, stream>>>(PB, PLE, 0, W16(ws, l, WO_WPP), PLE, S, nv::EpiBf{PROJ, DM});
        float* GT = (float*)(ws + WS_ACT);
        nv::gemm<nv::EpiF32><<<dim3(DM / 64, S / 64), 256, 0, stream>>>(XA, DM, 0, W16(ws, l, WO_WPG), DM, S, nv::EpiF32{GT, DM});
        nv::ple_rows<<<S / 4, 256, 0, stream>>>(out, GT, PROJ, XB);
        bf16* tmp = XA; XA = XB; XB = tmp; hin = out;
    }
}
```
